# Optimizing an MI355X kernel written in HIP

```python
import jax, jax.numpy as jnp
from jax import lax
import numpy as np

D_MODEL = 1024
BATCH = 4
SEQ = 4096
DEPTH = 1

CHUNK = 64
Q_BLOCK = 128
ML_HEADS = 4
ML_DQK = D_MODEL // 8
ML_DV = D_MODEL // 4
ML_QK = ML_HEADS * ML_DQK
ML_V = ML_HEADS * ML_DV
FOX_HEADS = 8
FOX_DH = D_MODEL // 8
FOX_W = FOX_HEADS * FOX_DH
D_FF = 2816
CONV_W = 3
GATE_CAP = 15.0
EPS = 1e-6
SPLITS = (ML_QK, ML_QK, ML_V, ML_HEADS, ML_HEADS, ML_V,
          FOX_W, FOX_W, FOX_W, FOX_HEADS, D_MODEL, D_MODEL)
D_IN = 2 * ML_QK + 2 * ML_V + 2 * ML_HEADS + 3 * FOX_W + FOX_HEADS + 2 * D_MODEL

kernel_name = "hybrid_mlstm_fox_convffn"


def rmsnorm(x, w):
    xf = x.astype(jnp.float32)
    y = xf * lax.rsqrt(jnp.mean(xf * xf, axis=-1, keepdims=True) + EPS)
    return (y * w.astype(jnp.float32)).astype(x.dtype)


def softcap(z):
    return GATE_CAP * jnp.tanh(z / GATE_CAP)


def causal_dwconv(u, w, b):
    S = u.shape[1]
    up = jnp.pad(u, ((0, 0), (CONV_W - 1, 0), (0, 0)))
    y = b
    for j in range(CONV_W):
        y = y + w[j] * up[:, j:j + S]
    return y


def mlstm_chunkwise(q, k, v, log_i, log_f):
    B, S, H, DK = q.shape
    DV = v.shape[-1]
    NC = S // CHUNK
    q = q.astype(jnp.float32) * (DK ** -0.5)
    k = k.astype(jnp.float32)
    v = v.astype(jnp.float32)

    def to_chunks(t):
        t = t.reshape((B, NC, CHUNK, H) + t.shape[3:])
        return jnp.moveaxis(t, (1, 3), (0, 2))

    causal = jnp.tril(jnp.ones((CHUNK, CHUNK), dtype=bool))

    def step(carry, xs):
        C, n, m = carry
        qc, kc, vc, li, lf = xs
        b = jnp.cumsum(lf, axis=-1)
        dmat = b[..., :, None] - b[..., None, :] + li[..., None, :]
        dmat = jnp.where(causal, dmat, -jnp.inf)
        inter = b + m[..., None]
        m_t = jnp.maximum(inter, jnp.max(dmat, axis=-1))
        w_intra = jnp.exp(dmat - m_t[..., None])
        w_inter = jnp.exp(inter - m_t)
        s = jnp.einsum('bhtd,bhsd->bhts', qc, kc) * w_intra
        num = (jnp.einsum('bhts,bhsv->bhtv', s, vc)
               + w_inter[..., None] * jnp.einsum('bhvd,bhtd->bhtv', C, qc))
        den = jnp.sum(s, axis=-1) + w_inter * jnp.einsum('bhd,bhtd->bht', n, qc)
        h = num / jnp.maximum(jnp.abs(den), jnp.exp(-m_t))[..., None]
        b_last = b[..., -1]
        g = b_last[..., None] - b + li
        m_new = jnp.maximum(b_last + m, jnp.max(g, axis=-1))
        a = jnp.exp(b_last + m - m_new)
        wk = jnp.exp(g - m_new[..., None])
        C_new = a[..., None, None] * C + jnp.einsum('bhs,bhsv,bhsd->bhvd', wk, vc, kc)
        n_new = a[..., None] * n + jnp.einsum('bhs,bhsd->bhd', wk, kc)
        return (C_new, n_new, m_new), h

    init = (jnp.zeros((B, H, DV, DK), jnp.float32),
            jnp.zeros((B, H, DK), jnp.float32),
            jnp.zeros((B, H), jnp.float32))
    xs = (to_chunks(q), to_chunks(k), to_chunks(v), to_chunks(log_i), to_chunks(log_f))
    _, hs = lax.scan(step, init, xs)
    return jnp.moveaxis(hs, (0, 2), (1, 3)).reshape(B, S, H, DV)


def forgetting_attention(q, k, v, log_f):
    B, S, H, D = q.shape
    nb = S // Q_BLOCK
    F = jnp.moveaxis(jnp.cumsum(log_f, axis=1), 1, 2)
    qb = q.reshape(B, nb, Q_BLOCK, H, D).transpose(1, 0, 3, 2, 4)
    Fb = F.reshape(B, H, nb, Q_BLOCK).transpose(2, 0, 1, 3)
    kpos = jnp.arange(S)
    scale = D ** -0.5

    def block(args):
        qi, Fi, i = args
        logits = (jnp.einsum('bhqd,bshd->bhqs', qi, k).astype(jnp.float32) * scale
                  + Fi[..., None] - F[:, :, None, :])
        qpos = i * Q_BLOCK + jnp.arange(Q_BLOCK)
        logits = jnp.where(kpos[None, :] <= qpos[:, None], logits, -jnp.inf)
        p = jax.nn.softmax(logits, axis=-1)
        return jnp.einsum('bhqs,bshd->bqhd', p.astype(v.dtype), v)

    out = lax.map(block, (qb, Fb, jnp.arange(nb)))
    return out.transpose(1, 0, 2, 3, 4).reshape(B, S, H, D)


def setup_inputs(seed: int = 0) -> dict:
    key = jax.random.key(seed)
    ks = jax.random.split(key, 19)
    f32 = jnp.float32

    def dense(k, fan_in, shape):
        return jax.random.normal(k, (DEPTH,) + shape, f32) * fan_in ** -0.5

    def around(k, n, center):
        return center + 0.05 * jax.random.normal(k, (DEPTH, n), f32)

    return {
        "x": jax.random.normal(ks[0], (BATCH, SEQ, D_MODEL), f32),
        "norm_mix_pre": around(ks[1], D_MODEL, 1.0),
        "w_in": dense(ks[2], D_MODEL, (D_MODEL, D_IN)),
        "b_ml_i": around(ks[3], ML_HEADS, 0.0),
        "b_ml_f": around(ks[4], ML_HEADS, jnp.linspace(3.0, 6.0, ML_HEADS)),
        "ml_head_norm": around(ks[5], ML_V, 1.0),
        "b_fox_f": around(ks[6], FOX_HEADS, 2.0),
        "b_gate_a": around(ks[7], D_MODEL, 0.0),
        "b_gate_b": around(ks[8], D_MODEL, 0.0),
        "w_branch_a": dense(ks[9], ML_V, (ML_V, D_MODEL)),
        "w_branch_b": dense(ks[10], FOX_W, (FOX_W, D_MODEL)),
        "w_out": dense(ks[11], D_MODEL, (D_MODEL, D_MODEL)),
        "norm_mix_post": around(ks[12], D_MODEL, 1.0),
        "norm_ffn_pre": around(ks[13], D_MODEL, 1.0),
        "w_up": dense(ks[14], D_MODEL, (D_MODEL, 2 * D_FF)),
        "conv_w": dense(ks[15], CONV_W, (CONV_W, 2 * D_FF)),
        "conv_b": around(ks[16], 2 * D_FF, 0.0),
        "w_down": dense(ks[17], D_FF, (D_FF, D_MODEL)),
        "norm_ffn_post": around(ks[18], D_MODEL, 1.0),
    }


def reference(x, norm_mix_pre, w_in, b_ml_i, b_ml_f, ml_head_norm, b_fox_f, b_gate_a, b_gate_b,
              w_branch_a, w_branch_b, w_out, norm_mix_post, norm_ffn_pre, w_up, conv_w, conv_b,
              w_down, norm_ffn_post):
    B, S, _ = x.shape
    f32 = jnp.float32
    offsets = np.cumsum(SPLITS)[:-1].tolist()
    for l in range(DEPTH):
        h = rmsnorm(x, norm_mix_pre[l])
        proj = h @ w_in[l]
        (q_m, k_m, v_m, i_m, f_m, o_m,
         q_f, k_f, v_f, f_f, g_a, g_b) = jnp.split(proj, offsets, axis=-1)

        log_i = softcap(i_m.astype(f32) + b_ml_i[l])
        log_f = jax.nn.log_sigmoid(softcap(f_m.astype(f32) + b_ml_f[l]))
        h_a = mlstm_chunkwise(q_m.reshape(B, S, ML_HEADS, ML_DQK),
                              k_m.reshape(B, S, ML_HEADS, ML_DQK),
                              v_m.reshape(B, S, ML_HEADS, ML_DV), log_i, log_f)
        h_a = rmsnorm(h_a, ml_head_norm[l].reshape(ML_HEADS, ML_DV))
        h_a = h_a.reshape(B, S, ML_V).astype(x.dtype) * jax.nn.sigmoid(o_m)
        y_a = h_a @ w_branch_a[l]

        log_fg = jax.nn.log_sigmoid(f_f.astype(f32) + b_fox_f[l])
        h_b = forgetting_attention(q_f.reshape(B, S, FOX_HEADS, FOX_DH),
                                   k_f.reshape(B, S, FOX_HEADS, FOX_DH),
                                   v_f.reshape(B, S, FOX_HEADS, FOX_DH), log_fg)
        y_b = h_b.reshape(B, S, FOX_W) @ w_branch_b[l]

        merged = jax.nn.sigmoid(g_a + b_gate_a[l]) * y_a + jax.nn.sigmoid(g_b + b_gate_b[l]) * y_b
        x = x + rmsnorm(merged @ w_out[l], norm_mix_post[l])

        h = rmsnorm(x, norm_ffn_pre[l])
        u = causal_dwconv(h @ w_up[l], conv_w[l], conv_b[l])
        a, g = jnp.split(u, 2, axis=-1)
        x = x + rmsnorm((jax.nn.gelu(g) * a) @ w_down[l], norm_ffn_post[l])
    return x
```

```cpp
#include <hip/hip_runtime.h>
#include <cstdint>
#include <cstdio>

typedef unsigned short bf16;
constexpr int NB = 4, S = 4096, D = 1024, T = NB * S;
constexpr int MLH = 4, DQK = 128, DV = 256, FXH = 8, FDH = 128, DFF = 2816, DIN = 8208;
constexpr float EPS = 1e-6f, CAP = 15.f;
constexpr int C_QM = 0, C_KM = 512, C_VM = 1024, C_IM = 2048, C_FM = 2052, C_OM = 2056, C_QF = 3080, C_KF = 4104, C_VF = 5128, C_FF = 6152, C_GA = 6160, C_GB = 7184;
static_assert(C_GB + 1024 == DIN, "split");

constexpr size_t MiB = 1u << 20;
constexpr size_t WS_CTL = 0, WS_GP = 1 * MiB, WS_FOXF = 2 * MiB, WS_MLC = 2 * MiB + 512 * 1024, WS_MLM = 2 * MiB + 768 * 1024, WS_MLFL = 3 * MiB;
constexpr size_t WS_XN = 28 * MiB, WS_QM = 60 * MiB, WS_KM = 76 * MiB, WS_MERGED = 60 * MiB, WS_VM = 92 * MiB, WS_OM = 124 * MiB, WS_QF = 156 * MiB, WS_SGA = 188 * MiB, WS_SGB = 220 * MiB;
constexpr size_t WS_ACT = 60 * MiB, WS_Y = 156 * MiB, WS_UB = 156 * MiB, WS_END = 256 * MiB;

__device__ __forceinline__ float bf2f(bf16 v) { return __uint_as_float((unsigned)v << 16); }
__device__ __forceinline__ bf16 f2bf(float f) { unsigned u = __float_as_uint(f); return (bf16)((u + 0x7fffu + ((u >> 16) & 1u)) >> 16); }
__device__ __forceinline__ float bfr(float f) { return bf2f(f2bf(f)); }
__device__ __forceinline__ float wave_sum(float v) {
#pragma unroll
    for (int o = 1; o < 64; o <<= 1) v += __shfl_xor(v, o);
    return v;
}
__device__ __forceinline__ float sigmoidf_(float z) { return 1.f / (1.f + __expf(-z)); }
__device__ __forceinline__ float log_sigmoid(float z) { return fminf(z, 0.f) - log1pf(expf(-fabsf(z))); }
__device__ __forceinline__ float softcap(float z) { return CAP * tanhf(z / CAP); }
__device__ __forceinline__ float gelu_tanh(float x) { const float u = 0.7978845608028654f * (x + 0.044715f * x * x * x); return 0.5f * x * (1.f + tanhf(u)); }

__global__ void __launch_bounds__(256) k_prologue(const float* __restrict__ x, const float* __restrict__ wn, const float* __restrict__ w_in, bf16* __restrict__ XN, float* __restrict__ GP) {
    const int wave = (blockIdx.x * 256 + threadIdx.x) >> 6, lane = threadIdx.x & 63;
    if (wave >= T) return;
    const float* xr = x + (size_t)wave * D;
    float v[16]; float ss = 0.f;
#pragma unroll
    for (int j = 0; j < 16; ++j) { v[j] = xr[j * 64 + lane]; ss += v[j] * v[j]; }
    ss = wave_sum(ss);
    const float r = rsqrtf(ss * (1.f / D) + EPS);
    float g[16];
#pragma unroll
    for (int c = 0; c < 16; ++c) g[c] = 0.f;
#pragma unroll
    for (int j = 0; j < 16; ++j) {
        const int k = j * 64 + lane; const float h = v[j] * r * wn[k];
        XN[(size_t)wave * D + k] = f2bf(h);
        const float* wr = w_in + (size_t)k * DIN;
#pragma unroll
        for (int c = 0; c < 4; ++c) { g[c] += h * wr[C_IM + c]; g[4 + c] += h * wr[C_FM + c]; }
#pragma unroll
        for (int c = 0; c < 8; ++c) g[8 + c] += h * wr[C_FF + c];
    }
#pragma unroll
    for (int c = 0; c < 16; ++c) { const float s = wave_sum(g[c]); if (lane == c) GP[(size_t)wave * 16 + c] = s; }
}

template <class Epi>
__global__ void __launch_bounds__(256) k_gemm(const bf16* __restrict__ A, int lda, const float* __restrict__ W, int ldw, int M, int N, int K, Epi epi) {
    __shared__ float As[16][132];
    __shared__ float Bs[16][132];
    const int tid = threadIdx.x, tx = tid & 15, ty = tid >> 4;
    const int m0 = blockIdx.y * 128, n0 = blockIdx.x * 128;
    float acc[8][8];
#pragma unroll
    for (int i = 0; i < 8; ++i)
#pragma unroll
        for (int j = 0; j < 8; ++j) acc[i][j] = 0.f;
    for (int k0 = 0; k0 < K; k0 += 16) {
#pragma unroll
        for (int i = 0; i < 8; ++i) { const int e = tid + i * 256, r = e >> 4, c = e & 15; As[c][r] = bf2f(A[(size_t)(m0 + r) * lda + k0 + c]); }
#pragma unroll
        for (int i = 0; i < 8; ++i) { const int e = tid + i * 256, r = e >> 7, c = e & 127; const int n = n0 + c; Bs[r][c] = (n < N) ? bfr(W[(size_t)(k0 + r) * ldw + n]) : 0.f; }
        __syncthreads();
#pragma unroll
        for (int k = 0; k < 16; ++k) {
            float a[8], b[8];
#pragma unroll
            for (int i = 0; i < 8; ++i) a[i] = As[k][ty * 8 + i];
#pragma unroll
            for (int j = 0; j < 8; ++j) b[j] = Bs[k][tx * 8 + j];
#pragma unroll
            for (int i = 0; i < 8; ++i)
#pragma unroll
                for (int j = 0; j < 8; ++j) acc[i][j] += a[i] * b[j];
        }
        __syncthreads();
    }
#pragma unroll
    for (int i = 0; i < 8; ++i)
#pragma unroll
        for (int j = 0; j < 8; ++j) { const int m = m0 + ty * 8 + i, n = n0 + tx * 8 + j; if (m < M && n < N) epi(m, n, acc[i][j]); }
}
struct EpiStoreBf { bf16* O; int ld; int pad; __device__ void operator()(int m, int n, float v) const { O[(size_t)m * ld + n] = f2bf(v); } };
struct EpiSigBf { bf16* O; const float* bias; int ld; int pad; __device__ void operator()(int m, int n, float v) const { O[(size_t)m * ld + n] = f2bf(sigmoidf_(v + bias[n])); } };
struct EpiStoreF { float* O; int ld; int pad; __device__ void operator()(int m, int n, float v) const { O[(size_t)m * ld + n] = v; } };
struct EpiMerge { bf16* O; const bf16* G; int ld; int add; __device__ void operator()(int m, int n, float v) const {
    const size_t i = (size_t)m * ld + n; float r = bf2f(G[i]) * v; if (add) r += bf2f(O[i]); O[i] = f2bf(r); } };

__global__ void k_scan(const float* __restrict__ GP, const float* __restrict__ b_i, const float* __restrict__ b_f, const float* __restrict__ b_ff,
                       float* __restrict__ FOXF, float* __restrict__ MLC, float* __restrict__ MLM, float* __restrict__ MLFL) {
    const int id = blockIdx.x * blockDim.x + threadIdx.x;
    if (id < NB * MLH) {
        const int b = id / MLH, h = id % MLH;
        float Bc = 0.f, Mx = -INFINITY;
        for (int s = 0; s < S; ++s) {
            const float* g = GP + (size_t)(b * S + s) * 16;
            const float li = softcap(g[h] + b_i[h]);
            const float lf = log_sigmoid(softcap(g[4 + h] + b_f[h]));
            Bc += lf;
            const float c = li - Bc; Mx = fmaxf(Mx, c);
            const size_t o = (size_t)(b * MLH + h) * S + s;
            MLC[o] = c; MLM[o] = Mx; MLFL[o] = -Bc - Mx;
        }
    } else if (id < NB * MLH + NB * FXH) {
        const int j = id - NB * MLH, b = j / FXH, h = j % FXH;
        float F = 0.f;
        for (int s = 0; s < S; ++s) {
            F += log_sigmoid(GP[(size_t)(b * S + s) * 16 + 8 + h] + b_ff[h]);
            FOXF[(size_t)(b * FXH + h) * S + s] = F;
        }
    }
}

__global__ void __launch_bounds__(256) k_fox(const bf16* QF, const bf16* __restrict__ KF, const bf16* __restrict__ VF, const float* __restrict__ FOXF, bf16* HB) {
    const int wave = (blockIdx.x * 256 + threadIdx.x) >> 6, lane = threadIdx.x & 63;
    const int t = wave % S, h = (wave / S) % FXH, b = wave / (S * FXH);
    const size_t qoff = (size_t)(b * S + t) * D + h * FDH + 2 * lane;
    const float q0 = bf2f(QF[qoff]), q1 = bf2f(QF[qoff + 1]);
    const float* Fh = FOXF + (size_t)(b * FXH + h) * S; const float Ft = Fh[t];
    float m = -INFINITY, l = 0.f, o0 = 0.f, o1 = 0.f; const float scale = 0.08838834764831845f;
    for (int s = 0; s <= t; ++s) {
        const size_t ko = (size_t)(b * S + s) * D + h * FDH + 2 * lane;
        const float d = wave_sum(q0 * bf2f(KF[ko]) + q1 * bf2f(KF[ko + 1]));
        const float lg = d * scale + (Ft - Fh[s]);
        const float mn = fmaxf(m, lg), al = __expf(m - mn), p = __expf(lg - mn);
        l = l * al + p; o0 = o0 * al + p * bf2f(VF[ko]); o1 = o1 * al + p * bf2f(VF[ko + 1]); m = mn;
    }
    HB[qoff] = f2bf(o0 / l); HB[qoff + 1] = f2bf(o1 / l);
}

__global__ void __launch_bounds__(256) k_mlstm(const bf16* __restrict__ QM, const bf16* __restrict__ KM, const bf16* __restrict__ VM, bf16* OMHA,
                                               const float* __restrict__ MLC, const float* __restrict__ MLM, const float* __restrict__ MLFL, const float* __restrict__ w_head) {
    const int wave = (blockIdx.x * 256 + threadIdx.x) >> 6, lane = threadIdx.x & 63;
    const int t = wave % S, h = (wave / S) % MLH, b = wave / (S * MLH);
    const size_t qo = (size_t)(b * S + t) * 512 + h * DQK + 2 * lane;
    const float q0 = bf2f(QM[qo]), q1 = bf2f(QM[qo + 1]);
    const size_t go = (size_t)(b * MLH + h) * S;
    const float Mt = MLM[go + t], scale = 0.08838834764831845f;
    float den = 0.f, o[4] = {0.f, 0.f, 0.f, 0.f};
    for (int s = 0; s <= t; ++s) {
        const size_t ko = (size_t)(b * S + s) * 512 + h * DQK + 2 * lane;
        const float d = wave_sum(q0 * bf2f(KM[ko]) + q1 * bf2f(KM[ko + 1]));
        const float w = d * scale * __expf(MLC[go + s] - Mt);
        den += w;
        const bf16* vr = VM + (size_t)(b * S + s) * 1024 + h * DV + 4 * lane;
#pragma unroll
        for (int j = 0; j < 4; ++j) o[j] += w * bf2f(vr[j]);
    }
    const float dn = fmaxf(fabsf(den), __expf(MLFL[go + t]));
    float ss = 0.f;
#pragma unroll
    for (int j = 0; j < 4; ++j) { o[j] /= dn; ss += o[j] * o[j]; }
    ss = wave_sum(ss);
    const float r = rsqrtf(ss * (1.f / DV) + EPS);
    const size_t oo = (size_t)(b * S + t) * 1024 + h * DV + 4 * lane;
#pragma unroll
    for (int j = 0; j < 4; ++j) { const float om = bf2f(OMHA[oo + j]); OMHA[oo + j] = f2bf(o[j] * r * w_head[h * DV + 4 * lane + j] * sigmoidf_(om)); }
}

__global__ void __launch_bounds__(256) k_rownorm(const float* __restrict__ Y, const float* base, const float* __restrict__ w, float* out, const float* __restrict__ w2, bf16* XN2) {
    const int wave = (blockIdx.x * 256 + threadIdx.x) >> 6, lane = threadIdx.x & 63;
    if (wave >= T) return;
    float v[16]; float ss = 0.f;
#pragma unroll
    for (int j = 0; j < 16; ++j) { v[j] = Y[(size_t)wave * D + j * 64 + lane]; ss += v[j] * v[j]; }
    const float r = rsqrtf(wave_sum(ss) * (1.f / D) + EPS);
    float s2 = 0.f;
#pragma unroll
    for (int j = 0; j < 16; ++j) { const int k = j * 64 + lane; v[j] = base[(size_t)wave * D + k] + v[j] * r * w[k]; s2 += v[j] * v[j]; }
#pragma unroll
    for (int j = 0; j < 16; ++j) out[(size_t)wave * D + j * 64 + lane] = v[j];
    if (XN2) { const float r2 = rsqrtf(wave_sum(s2) * (1.f / D) + EPS);
#pragma unroll
        for (int j = 0; j < 16; ++j) { const int k = j * 64 + lane; XN2[(size_t)wave * D + k] = f2bf(v[j] * r2 * w2[k]); } }
}

__global__ void __launch_bounds__(256) k_conv(const float* __restrict__ U, const float* __restrict__ cw, const float* __restrict__ cb, bf16* __restrict__ act_b) {
    const size_t id = (size_t)blockIdx.x * 256 + threadIdx.x;
    if (id >= (size_t)S * DFF) return;
    const int t = (int)(id / DFF), c = (int)(id % DFF);
    float ya = cb[c], yg = cb[DFF + c];
#pragma unroll
    for (int j = 0; j < 3; ++j) { const int tt = t - 2 + j; if (tt >= 0) { ya += cw[j * 2 * DFF + c] * U[(size_t)tt * 2 * DFF + c]; yg += cw[j * 2 * DFF + DFF + c] * U[(size_t)tt * 2 * DFF + DFF + c]; } }
    act_b[(size_t)t * DFF + c] = f2bf(gelu_tanh(yg) * ya);
}

template <class Epi> static void gemm(const bf16* A, int lda, const float* W, int ldw, int M, int N, int K, Epi e, hipStream_t st) {
    dim3 g((N + 127) / 128, M / 128);
    k_gemm<Epi><<<g, 256, 0, st>>>(A, lda, W, ldw, M, N, K, e);
}

extern "C" void kernel_launch(void* const* d_in, const int* in_sizes, int n_in, void* d_out, int out_size, void* d_ws, size_t ws_size, hipStream_t stream) {
    if (n_in != 19 || in_sizes[0] != T * D || out_size != T * D || ws_size < WS_END) { fprintf(stderr, "kernel_launch: unexpected shapes/ws (%d %d %d %zu)\n", n_in, n_in > 0 ? in_sizes[0] : -1, out_size, ws_size); return; }
    const float* x = (const float*)d_in[0]; const float* n_pre = (const float*)d_in[1]; const float* w_in = (const float*)d_in[2];
    const float* b_i = (const float*)d_in[3]; const float* b_f = (const float*)d_in[4]; const float* w_head = (const float*)d_in[5]; const float* b_ff = (const float*)d_in[6];
    const float* b_ga = (const float*)d_in[7]; const float* b_gb = (const float*)d_in[8]; const float* w_a = (const float*)d_in[9]; const float* w_b = (const float*)d_in[10];
    const float* w_out = (const float*)d_in[11]; const float* n_post = (const float*)d_in[12]; const float* n_fpre = (const float*)d_in[13]; const float* w_up = (const float*)d_in[14];
    const float* cw = (const float*)d_in[15]; const float* cb = (const float*)d_in[16]; const float* w_down = (const float*)d_in[17]; const float* n_fpost = (const float*)d_in[18];
    char* ws = (char*)d_ws; float* out = (float*)d_out;
    bf16* XN = (bf16*)(ws + WS_XN); float* GP = (float*)(ws + WS_GP);
    bf16 *QM = (bf16*)(ws + WS_QM), *KM = (bf16*)(ws + WS_KM), *VM = (bf16*)(ws + WS_VM), *OM = (bf16*)(ws + WS_OM), *QF = (bf16*)(ws + WS_QF), *SGA = (bf16*)(ws + WS_SGA), *SGB = (bf16*)(ws + WS_SGB);
    bf16 *KF = (bf16*)d_out, *VF = (bf16*)((char*)d_out + 32 * MiB);
    float *FOXF = (float*)(ws + WS_FOXF), *MLC = (float*)(ws + WS_MLC), *MLM = (float*)(ws + WS_MLM), *MLFL = (float*)(ws + WS_MLFL);
    bf16* MERGED = (bf16*)(ws + WS_MERGED); float* Y = (float*)(ws + WS_Y); bf16* ACT = (bf16*)(ws + WS_ACT); float* UB = (float*)(ws + WS_UB);

    k_prologue<<<T / 4, 256, 0, stream>>>(x, n_pre, w_in, XN, GP);
    gemm(XN, D, w_in + C_QM, DIN, T, 512, D, EpiStoreBf{QM, 512, 0}, stream);
    gemm(XN, D, w_in + C_KM, DIN, T, 512, D, EpiStoreBf{KM, 512, 0}, stream);
    gemm(XN, D, w_in + C_VM, DIN, T, 1024, D, EpiStoreBf{VM, 1024, 0}, stream);
    gemm(XN, D, w_in + C_OM, DIN, T, 1024, D, EpiStoreBf{OM, 1024, 0}, stream);
    gemm(XN, D, w_in + C_QF, DIN, T, 1024, D, EpiStoreBf{QF, 1024, 0}, stream);
    gemm(XN, D, w_in + C_KF, DIN, T, 1024, D, EpiStoreBf{KF, 1024, 0}, stream);
    gemm(XN, D, w_in + C_VF, DIN, T, 1024, D, EpiStoreBf{VF, 1024, 0}, stream);
    gemm(XN, D, w_in + C_GA, DIN, T, 1024, D, EpiSigBf{SGA, b_ga, 1024, 0}, stream);
    gemm(XN, D, w_in + C_GB, DIN, T, 1024, D, EpiSigBf{SGB, b_gb, 1024, 0}, stream);
    k_scan<<<1, 64, 0, stream>>>(GP, b_i, b_f, b_ff, FOXF, MLC, MLM, MLFL);
    k_mlstm<<<NB * MLH * S / 4, 256, 0, stream>>>(QM, KM, VM, OM, MLC, MLM, MLFL, w_head);
    k_fox<<<NB * FXH * S / 4, 256, 0, stream>>>(QF, KF, VF, FOXF, QF);
    gemm(OM, D, w_a, D, T, D, D, EpiMerge{MERGED, SGA, D, 0}, stream);
    gemm(QF, D, w_b, D, T, D, D, EpiMerge{MERGED, SGB, D, 1}, stream);
    gemm(MERGED, D, w_out, D, T, D, D, EpiStoreF{Y, D, 0}, stream);
    k_rownorm<<<T / 4, 256, 0, stream>>>(Y, x, n_post, out, n_fpre, XN);
    for (int b = 0; b < NB; ++b) {
        gemm(XN + (size_t)b * S * D, D, w_up, 2 * DFF, S, 2 * DFF, D, EpiStoreF{UB, 2 * DFF, 0}, stream);
        k_conv<<<(S * DFF + 255) / 256, 256, 0, stream>>>(UB, cw, cb, ACT + (size_t)b * S * DFF);
    }
    gemm(ACT, DFF, w_down, D, T, D, DFF, EpiStoreF{Y, D, 0}, stream);
    k_rownorm<<<T / 4, 256, 0, stream>>>(Y, out, n_fpost, out, nullptr, nullptr);
}
```
